# Optimizing an MI355X kernel written in HIP

```python
import jax, jax.numpy as jnp
from jax import lax
import numpy as np

D_MODEL = 2048
BATCH = 4
SEQ = 2048
DEPTH = 2

ATT_HEAD_DIM = 64
ATT_Q_HEADS = 16
ATT_KV_HEADS = 4
ATT_GROUP = ATT_Q_HEADS // ATT_KV_HEADS
WINDOW = 128
ATT_BLOCK = 128
RET_HEADS = 8
RET_HEAD_DIM = 128
RET_V_DIM = 128
RET_CHUNK = 128
ROPE_THETA = 10000.0
N_GROUPS = 4
EXPERTS_PER_GROUP = 4
N_EXPERTS = N_GROUPS * EXPERTS_PER_GROUP
TOP_K = 2
D_FF = 1024
EPS = 1e-6

ATT_Q_W = ATT_Q_HEADS * ATT_HEAD_DIM
ATT_KV_W = ATT_KV_HEADS * ATT_HEAD_DIM
RET_QK_W = RET_HEADS * RET_HEAD_DIM
RET_V_W = RET_HEADS * RET_V_DIM
IN_SPLITS = (ATT_Q_W, ATT_KV_W, ATT_KV_W, RET_QK_W, RET_QK_W, RET_V_W, RET_V_W, D_MODEL, D_MODEL)
IN_W = ATT_Q_W + 2 * ATT_KV_W + 2 * RET_QK_W + 2 * RET_V_W + 2 * D_MODEL

kernel_name = "hybrid_swa_retention_grouped_moe_adaln"


def rms_norm(x, g):
    xf = x.astype(jnp.float32)
    y = xf * lax.rsqrt(jnp.mean(xf * xf, axis=-1, keepdims=True) + EPS)
    return (y * g.astype(jnp.float32)).astype(x.dtype)


def modulate(h, shift, scale):
    return h * (1.0 + scale[:, None, :]) + shift[:, None, :]


def rope(x, pos):
    d = x.shape[-1]
    half = d // 2
    inv_freq = ROPE_THETA ** (-2.0 * jnp.arange(half, dtype=jnp.float32) / d)
    ang = pos.astype(jnp.float32)[..., None] * inv_freq
    cos = jnp.cos(ang)[:, :, None, :]
    sin = jnp.sin(ang)[:, :, None, :]
    xf = x.astype(jnp.float32)
    x1, x2 = xf[..., :half], xf[..., half:]
    out = jnp.concatenate([x1 * cos - x2 * sin, x2 * cos + x1 * sin], axis=-1)
    return out.astype(x.dtype)


def sliding_window_attention(q, k, v, sinks):
    B, S = q.shape[0], q.shape[1]
    W = ATT_BLOCK
    N = S // W
    qb = q.reshape(B, N, W, ATT_KV_HEADS, ATT_GROUP, ATT_HEAD_DIM)
    kb = k.reshape(B, N, W, ATT_KV_HEADS, ATT_HEAD_DIM)
    vb = v.reshape(B, N, W, ATT_KV_HEADS, ATT_HEAD_DIM)
    pad = ((0, 0), (1, 0), (0, 0), (0, 0), (0, 0))
    kcat = jnp.concatenate([jnp.pad(kb, pad)[:, :-1], kb], axis=2)
    vcat = jnp.concatenate([jnp.pad(vb, pad)[:, :-1], vb], axis=2)
    s = jnp.einsum('bnqhgd,bnkhd->bhgnqk', qb, kcat).astype(jnp.float32) * (ATT_HEAD_DIM ** -0.5)
    qi = jnp.arange(W)[:, None]
    kj = jnp.arange(2 * W)[None, :]
    rel = qi + W - kj
    band = (rel >= 0) & (rel < WINDOW)
    valid = (jnp.arange(N)[:, None, None] > 0) | (kj >= W)[None]
    mask = band[None] & valid
    s = jnp.where(mask, s, -jnp.inf)
    sink = jnp.broadcast_to(
        sinks.astype(jnp.float32).reshape(ATT_KV_HEADS, ATT_GROUP)[None, :, :, None, None, None],
        s.shape[:-1] + (1,))
    p = jax.nn.softmax(jnp.concatenate([s, sink], axis=-1), axis=-1)[..., :-1]
    o = jnp.einsum('bhgnqk,bnkhd->bnqhgd', p.astype(v.dtype), vcat)
    return o.reshape(B, S, ATT_Q_W)


def chunk_retention(q, k, v):
    B, S = q.shape[0], q.shape[1]
    C = RET_CHUNK
    N = S // C
    log_g = jnp.log1p(-jnp.exp2(-5.0 - jnp.arange(RET_HEADS, dtype=jnp.float32)))
    qc = q.reshape(B, N, C, RET_HEADS, RET_HEAD_DIM)
    kc = k.reshape(B, N, C, RET_HEADS, RET_HEAD_DIM)
    vc = v.reshape(B, N, C, RET_HEADS, RET_V_DIM)
    i = jnp.arange(C, dtype=jnp.float32)
    diff = i[:, None] - i[None, :]
    intra_decay = jnp.where(diff[None] >= 0,
                            jnp.exp(jnp.maximum(diff, 0.0)[None] * log_g[:, None, None]), 0.0)
    scores = jnp.einsum('bnihd,bnjhd->bnhij', qc, kc) * intra_decay
    intra = jnp.einsum('bnhij,bnjhe->bnihe', scores, vc)
    k_decay = jnp.exp((C - 1.0 - i)[None, :] * log_g[:, None])
    kv = jnp.einsum('bnjhd,bnjhe,hj->nbhde', kc, vc, k_decay)
    chunk_decay = jnp.exp(C * log_g)[None, :, None, None]

    def step(state, kv_n):
        return chunk_decay * state + kv_n, state

    init = jnp.zeros((B, RET_HEADS, RET_HEAD_DIM, RET_V_DIM), jnp.float32)
    _, prev = lax.scan(step, init, kv)
    q_decay = jnp.exp((i + 1.0)[None, :] * log_g[:, None])
    cross = jnp.einsum('bnihd,hi,nbhde->bnihe', qc, q_decay, prev)
    return (intra + cross).reshape(B, S, RET_HEADS, RET_V_DIM)


def grouped_moe(h, w_router, b_router, w_gate, w_up, w_down):
    B, S, D = h.shape
    t = h.reshape(-1, D)
    logits = (t @ w_router).astype(jnp.float32) + b_router.astype(jnp.float32)
    probs = jax.nn.softmax(logits, axis=-1)
    pg = probs.reshape(-1, N_GROUPS, EXPERTS_PER_GROUP)
    group_score = lax.top_k(pg, TOP_K)[0].sum(-1)
    gsel = jnp.argmax(group_score, axis=-1)
    p_in = jnp.take_along_axis(pg, gsel[:, None, None], axis=1)[:, 0]
    vals, idx = lax.top_k(p_in, TOP_K)
    wts = vals / jnp.sum(vals, axis=-1, keepdims=True)
    eid = gsel[:, None] * EXPERTS_PER_GROUP + idx
    comb = jnp.sum(jax.nn.one_hot(eid, N_EXPERTS, dtype=jnp.float32) * wts[..., None], axis=1)
    out = jnp.zeros(t.shape, jnp.float32)
    for e in range(N_EXPERTS):
        y = (jax.nn.silu(t @ w_gate[e]) * (t @ w_up[e])) @ w_down[e]
        out = out + comb[:, e:e + 1] * y.astype(jnp.float32)
    return out.astype(h.dtype).reshape(B, S, D)


def setup_inputs(seed: int = 0) -> dict:
    key = jax.random.key(seed)
    ks = jax.random.split(key, 20)
    f32 = jnp.float32
    D = D_MODEL

    def nrm(k, shape, scale):
        return jax.random.normal(k, shape, f32) * scale

    x = nrm(ks[0], (BATCH, SEQ, D), 1.0)
    c = nrm(ks[1], (BATCH, D), 1.0)
    positions = (jnp.arange(SEQ, dtype=jnp.int32)[None, :]
                 + jax.random.randint(ks[2], (BATCH, 1), 0, 1024, dtype=jnp.int32))
    return {
        "x": x,
        "c": c,
        "positions": positions,
        "w_ada": nrm(ks[3], (DEPTH, D, 6 * D), 0.5 * D ** -0.5),
        "b_ada": nrm(ks[4], (DEPTH, 6 * D), 0.01),
        "norm1_g": 1.0 + nrm(ks[5], (DEPTH, D), 0.05),
        "norm2_g": 1.0 + nrm(ks[6], (DEPTH, D), 0.05),
        "w_in": nrm(ks[7], (DEPTH, D, IN_W), D ** -0.5),
        "attn_sinks": nrm(ks[8], (DEPTH, ATT_Q_HEADS), 1.0),
        "w_attn_out": nrm(ks[9], (DEPTH, ATT_Q_W, D), ATT_Q_W ** -0.5),
        "ret_norm_g": 1.0 + nrm(ks[10], (DEPTH, RET_V_W), 0.05),
        "w_ret_out": nrm(ks[11], (DEPTH, RET_V_W, D), RET_V_W ** -0.5),
        "w_o": nrm(ks[12], (DEPTH, D, D), D ** -0.5),
        "w_router": nrm(ks[13], (D, N_EXPERTS), D ** -0.5),
        "b_router": nrm(ks[14], (N_EXPERTS,), 0.01),
        "w_gate": nrm(ks[15], (DEPTH, N_EXPERTS, D, D_FF), D ** -0.5),
        "w_up": nrm(ks[16], (DEPTH, N_EXPERTS, D, D_FF), D ** -0.5),
        "w_down": nrm(ks[17], (DEPTH, N_EXPERTS, D_FF, D), D_FF ** -0.5),
        "final_g": 1.0 + nrm(ks[18], (D,), 0.05),
    }


def reference(x, c, positions, w_ada, b_ada, norm1_g, norm2_g, w_in, attn_sinks,
              w_attn_out, ret_norm_g, w_ret_out, w_o, w_router, b_router,
              w_gate, w_up, w_down, final_g):
    B, S, D = x.shape
    offsets = [int(o) for o in np.cumsum(IN_SPLITS)[:-1]]
    c_act = jax.nn.silu(c)
    for l in range(DEPTH):
        mod = c_act @ w_ada[l] + b_ada[l]
        shift1, scale1, gate1, shift2, scale2, gate2 = jnp.split(mod, 6, axis=-1)

        h = modulate(rms_norm(x, norm1_g[l]), shift1, scale1)
        proj = h @ w_in[l]
        qa, ka, va, qr, kr, vr, gr, ga, gb = jnp.split(proj, offsets, axis=-1)

        qa = rope(qa.reshape(B, S, ATT_Q_HEADS, ATT_HEAD_DIM), positions)
        ka = rope(ka.reshape(B, S, ATT_KV_HEADS, ATT_HEAD_DIM), positions)
        va = va.reshape(B, S, ATT_KV_HEADS, ATT_HEAD_DIM)
        ya = sliding_window_attention(qa, ka, va, attn_sinks[l]) @ w_attn_out[l]

        qr = rope(qr.reshape(B, S, RET_HEADS, RET_HEAD_DIM), positions).astype(jnp.float32)
        kr = rope(kr.reshape(B, S, RET_HEADS, RET_HEAD_DIM), positions).astype(jnp.float32) * (RET_HEAD_DIM ** -0.5)
        vr = vr.reshape(B, S, RET_HEADS, RET_V_DIM).astype(jnp.float32)
        yr = chunk_retention(qr, kr, vr)
        yr = yr * lax.rsqrt(jnp.mean(yr * yr, axis=-1, keepdims=True) + EPS)
        yr = yr * ret_norm_g[l].astype(jnp.float32).reshape(RET_HEADS, RET_V_DIM)
        yr = (jax.nn.silu(gr.astype(jnp.float32)) * yr.reshape(B, S, RET_V_W)).astype(x.dtype)
        yr = yr @ w_ret_out[l]

        merged = jax.nn.sigmoid(ga) * ya + jax.nn.sigmoid(gb) * yr
        x = x + gate1[:, None, :] * (merged @ w_o[l])

        h2 = modulate(rms_norm(x, norm2_g[l]), shift2, scale2)
        x = x + gate2[:, None, :] * grouped_moe(h2, w_router, b_router, w_gate[l], w_up[l], w_down[l])
    return rms_norm(x, final_g)
```

```cpp
#include <hip/hip_runtime.h>
#include <cstdint>
#include <cstdio>

#ifndef MK_ONE_LAUNCH
#define MK_ONE_LAUNCH 1
#endif

constexpr int NB = 4, SEQ = 2048, T = NB * SEQ, D = 2048, DEPTH = 2;
constexpr int INW = 9728, DFF = 1024, NEXP = 16;
constexpr int C_QA = 0, C_KA = 1024, C_VA = 1280, C_QR = 1536, C_KR = 2560, C_VR = 3584, C_GR = 4608, C_GA = 5632, C_GB = 7680;
constexpr float EPS = 1e-6f;
constexpr float LOG2E = 1.4426950408889634f;

#define GAS __attribute__((address_space(1)))
#define LAS __attribute__((address_space(3)))
typedef unsigned short bf16;
typedef short bf16x8 __attribute__((ext_vector_type(8)));
typedef float f32x4 __attribute__((ext_vector_type(4)));
typedef float f32x16 __attribute__((ext_vector_type(16)));
typedef unsigned u32x4 __attribute__((ext_vector_type(4)));
typedef unsigned u32x2 __attribute__((ext_vector_type(2)));
typedef float f32x2_t __attribute__((ext_vector_type(2)));
typedef __bf16 bf16x2_t __attribute__((ext_vector_type(2)));
typedef GAS unsigned gu32;

__device__ __forceinline__ unsigned pk2(float lo, float hi) { f32x2_t v = {lo, hi}; bf16x2_t b = __builtin_convertvector(v, bf16x2_t); return __builtin_bit_cast(unsigned, b); }
__device__ __forceinline__ float bf_lo(unsigned w) { return __uint_as_float(w << 16); }
__device__ __forceinline__ float bf_hi(unsigned w) { return __uint_as_float(w & 0xffff0000u); }
__device__ __forceinline__ float fexp2(float x) { return __builtin_amdgcn_exp2f(x); }
__device__ __forceinline__ float frcp(float x) { return __builtin_amdgcn_rcpf(x); }
__device__ __forceinline__ float sigmoidf_(float x) { return frcp(1.0f + fexp2(-x * LOG2E)); }
__device__ __forceinline__ float siluf_(float x) { return x * sigmoidf_(x); }
__device__ __forceinline__ int crow(int r, int hi) { return (r & 3) + 8 * (r >> 2) + 4 * hi; }
__device__ __forceinline__ float wave_sum(float v) {
#pragma unroll
    for (int o = 1; o < 64; o <<= 1) v += __shfl_xor(v, o);
    return v;
}

constexpr size_t MiB = 1u << 20;
constexpr size_t WS_CTL = 0, CTL_ZERO_BYTES = 1 * MiB;
constexpr size_t WS_MODP = 2 * MiB;
constexpr size_t WS_MOD = 9 * MiB;
constexpr size_t WS_ROPA_C = 10 * MiB, WS_ROPA_S = 11 * MiB;
constexpr size_t WS_ROPR_C = 12 * MiB, WS_ROPR_S = 14 * MiB;
constexpr size_t WS_LIST = 16 * MiB;
constexpr size_t WS_TW = 17 * MiB;
constexpr size_t WS_W = 32 * MiB;
constexpr size_t WL_IN = 0, WL_A = 38 * MiB, WL_R = 42 * MiB, WL_O = 46 * MiB, WL_GU = 54 * MiB, WL_D = 182 * MiB, WL_STRIDE = 246 * MiB;
constexpr size_t WS_H = 524 * MiB;
constexpr size_t WS_PROJ = 556 * MiB;
constexpr size_t WS_ACT = 556 * MiB;
constexpr size_t WS_YBUF = 596 * MiB;
constexpr size_t WS_AO = 708 * MiB;
constexpr size_t WS_KV = 740 * MiB;
constexpr size_t WS_T1 = 772 * MiB;
constexpr size_t WS_MG = 804 * MiB;
constexpr size_t WS_XA = 836 * MiB, WS_XB = 900 * MiB;
constexpr size_t WS_END = 964 * MiB;
constexpr int CW_TMO = 0;
constexpr int CW_BAR = 4096;
constexpr int CW_CNT = 16384;

constexpr int RING_BYTES = 131072;
constexpr int LDSCTL_OFF = RING_BYTES;
constexpr int MISC_OFF = LDSCTL_OFF + 64;
constexpr int MOE_OFF = LDSCTL_OFF + 256;
constexpr int TAB_OFF = LDSCTL_OFF + 1024;
constexpr int LDS_BYTES = 147456;

#define XB_TMO      128
#define XB_XCNT(j)  (256  + 64 * (j))
#define XB_XSUB(j)  (1280 + 64 * (j))
#define XB_XGEN(j)  (2304 + 64 * (j))
#define XB_TOP      3328
#define XB_TOPGEN   3392
#define XCD_BAR_WORDS 3456
#define XB_SPIN_CAP (1u << 18)

__device__ __forceinline__ unsigned xb_ld(unsigned* p)              { return __hip_atomic_load(p, __ATOMIC_RELAXED, __HIP_MEMORY_SCOPE_AGENT); }
__device__ __forceinline__ unsigned xb_add(unsigned* p, unsigned v) { return __hip_atomic_fetch_add(p, v, __ATOMIC_RELAXED, __HIP_MEMORY_SCOPE_AGENT); }
__device__ __forceinline__ unsigned xb_xcc_id() { return (unsigned)__builtin_amdgcn_s_getreg((3 << 11) | 20) & 0xFu; }
#define XB_SPIN(cond, bar) do { unsigned _sp = 0; while (cond) { __builtin_amdgcn_s_sleep(1); \
    if ((++_sp & 255u) == 0u) { if (xb_ld(&(bar)[XB_TMO])) break; if (_sp > XB_SPIN_CAP) { atomicAdd(&(bar)[XB_TMO], 1u); break; } } } } while (0)

struct XcdBarrier { unsigned* bar; unsigned x; volatile LAS unsigned* st; };

__device__ __forceinline__ XcdBarrier xcd_barrier_post(unsigned* bar, volatile LAS unsigned* st) {
    XcdBarrier b; b.bar = bar; b.x = xb_xcc_id(); b.st = st;
    if (threadIdx.x == 0) (void)xb_add(&bar[XB_XCNT(b.x)], 1u);
    return b;
}
__device__ __forceinline__ void xcd_barrier_complete(unsigned* bar, unsigned x, unsigned& nloc, unsigned& nx) {
    const unsigned G = gridDim.x * gridDim.y * gridDim.z;
    unsigned sum, cnt, mine, sp = 0u;
    for (;;) {
        sum = 0u; cnt = 0u; mine = 0u;
#pragma unroll
        for (unsigned j = 0; j < 16; ++j) { const unsigned c = xb_ld(&bar[XB_XCNT(j)]); sum += c; cnt += (c > 0u) ? 1u : 0u; mine = (j == x) ? c : mine; }
        if (sum == G) break;
        __builtin_amdgcn_s_sleep(1);
        if ((++sp & 255u) == 0u) { if (xb_ld(&bar[XB_TMO])) break; if (sp > XB_SPIN_CAP) { atomicAdd(&bar[XB_TMO], 1u); break; } }
    }
    nloc = mine > 0u ? mine : 1u; nx = cnt > 0u ? cnt : 1u;
}
__device__ __forceinline__ void xcd_barrier(const XcdBarrier& b) {
    asm volatile("s_waitcnt vmcnt(0)" ::: "memory");
    __syncthreads();
    if (threadIdx.x == 0) {
        unsigned* bar = b.bar;
        __builtin_amdgcn_s_waitcnt(0);
        unsigned nloc = b.st[0], nx = b.st[1];
        if (nloc == 0u) { xcd_barrier_complete(bar, b.x, nloc, nx); b.st[0] = nloc; b.st[1] = nx; }
        const unsigned old = xb_add(&bar[XB_XSUB(b.x)], 1u);
        const unsigned gen = old / nloc;
        if (old + 1u == (gen + 1u) * nloc) {
            __builtin_amdgcn_fence(__ATOMIC_RELEASE, "agent");
            asm volatile("s_waitcnt vmcnt(0)" ::: "memory");
            const unsigned og = xb_add(&bar[XB_TOP], 1u);
            const unsigned tg = og / nx;
            if (og + 1u == (tg + 1u) * nx) xb_add(&bar[XB_TOPGEN], 1u);
            else XB_SPIN(xb_ld(&bar[XB_TOPGEN]) == tg, bar);
            __builtin_amdgcn_fence(__ATOMIC_ACQUIRE, "agent");
            xb_add(&bar[XB_XGEN(b.x)], 1u);
            asm volatile("s_waitcnt vmcnt(0)" ::: "memory");
        } else {
            XB_SPIN(xb_ld(&bar[XB_XGEN(b.x)]) == gen, bar);
            __builtin_amdgcn_fence(__ATOMIC_ACQUIRE, "agent");
            asm volatile("s_waitcnt vmcnt(0)" ::: "memory");
        }
    }
    __syncthreads();
}

namespace pg8 {
constexpr int BM = 256, BK = 64, HALF = 128, HTB = HALF * BK * 2, STAGE_BYTES = 8 * HTB, NXCD = 8, WGM = 8;
__host__ __device__ __forceinline__ int lds_byte(int r, int c) { const int st = (r >> 4) * 2 + (c >> 5), rr = r & 15, cc = c & 31, ob = rr * 64 + cc * 2; return st * 1024 + (ob ^ (((ob >> 9) & 1) << 5)); }
__host__ __device__ __forceinline__ void stage_rc(int b, int& R, int& C) { const int st = b / 1024, sb = b % 1024, swz = sb ^ (((sb >> 9) & 1) << 5); R = (st >> 1) * 16 + swz / 64; C = (st & 1) * 32 + (swz % 64) / 2; }
__host__ __device__ __forceinline__ int perm32(int rho) { const int n = rho >> 4, i = rho & 15; return 8 * (i >> 2) + 4 * n + (i & 3); }

struct Unit { int pm, pn, slot; };
struct Gemm { const bf16* A; const bf16* Bt; int lda, ldb, K; };

struct StaticOrder {
    int nM, nN, nwg, G, c;
    __device__ void init(int M, int N, int G_, int c_) { nM = M / BM; nN = N / BM; nwg = nM * nN; G = G_; c = c_; }
    __device__ bool next(int i, Unit& u) const {
        const long L = (long)i * G + c; if (L >= nwg) return false;
        int wgid = (int)L; { const int q = nwg / NXCD, r = nwg % NXCD, xcd = wgid % NXCD, off = wgid / NXCD; wgid = (xcd < r ? xcd * (q + 1) : r * (q + 1) + (xcd - r) * q) + off; }
        const int nig = WGM * nN, gid = wgid / nig, fm = gid * WGM, gsz = (nM - fm) < WGM ? (nM - fm) : WGM;
        u.pm = fm + ((wgid % nig) % gsz); u.pn = (wgid % nig) / gsz; u.slot = i; return true;
    }
};
struct MoeOrder {
    const LAS int* moe; int G, c;
    __device__ bool next(int i, Unit& u) const {
        const int L = i * G + c; const int TT = moe[16 + 16];
        if (L >= TT * 8) return false;
        const int mt = L >> 3, nt = L & 7; int e = 0;
#pragma unroll
        for (int j = 1; j < 16; ++j) e += (mt >= moe[16 + j]) ? 1 : 0;
        u.pm = mt; u.pn = e * 8 + nt; u.slot = i; return true;
    }
};

template <class Epi, class Sched, bool GATHER>
__device__ __forceinline__ void gemm_phase(const int tid, LAS unsigned char* lds, const Gemm g, const Sched& S, const Epi& E, const LAS unsigned* rowtab) {
    const int wid = __builtin_amdgcn_readfirstlane(tid >> 6), lane = tid & 63, wr = wid >> 2, wc = wid & 3, fr = lane & 15, fq = lane >> 4;
    const int K = g.K, nt = K / BK;
    unsigned voffA[2], voffB[2]; int RA[2], CA[2];
#pragma unroll
    for (int i = 0; i < 2; ++i) { int R, C; stage_rc(tid * 16 + i * 8192, R, C); const int Rb = Epi::PERM ? ((R & ~31) + perm32(R & 31)) : R;
        RA[i] = R; CA[i] = C; voffA[i] = (unsigned)(R * g.lda + C) * 2u; voffB[i] = (unsigned)(Rb * g.ldb + C) * 2u; }
    const size_t kstep = (size_t)(BK * 2);
    const size_t hstepA = (size_t)HALF * g.lda * 2, hstepB = (size_t)HALF * g.ldb * 2;
    const size_t tstepA = 2 * hstepA, tstepB = 2 * hstepB;
    const unsigned ldsw = (unsigned)wid * 1024u;
    const int aoff = lds_byte(wr * 64 + fr, fq * 8), boff = lds_byte(wc * 32 + fr, fq * 8);
    unsigned goffC[2][2], goffN[2][2];
#define PG8_SA(b, h) (((b) * 2 + (h)) * HTB)
#define PG8_SB(b, h) ((4 + (b) * 2 + (h)) * HTB)
#define PG8_STAGE_B(bufoff, gbase) do { _Pragma("unroll") for (int _i = 0; _i < 2; ++_i) \
        __builtin_amdgcn_global_load_lds((const unsigned*)((const char*)(gbase) + voffB[_i]), (LAS unsigned*)(lds + (bufoff) + ldsw + _i * 8192), 16, 0, 0); } while (0)
#define PG8_STAGE_A(bufoff, aptr, half, nx) do { _Pragma("unroll") for (int _i = 0; _i < 2; ++_i) { const char* _g; \
        if constexpr (GATHER) _g = (const char*)(aptr) + ((nx) ? goffN[half][_i] : goffC[half][_i]); else _g = (const char*)(aptr) + (half) * hstepA + voffA[_i]; \
        __builtin_amdgcn_global_load_lds((const unsigned*)_g, (LAS unsigned*)(lds + (bufoff) + ldsw + _i * 8192), 16, 0, 0); } } while (0)
#define PG8_LDA(dst, b, h) do { _Pragma("unroll") for (int m = 0; m < 4; ++m) _Pragma("unroll") for (int k = 0; k < 2; ++k) dst[m][k] = *(const LAS bf16x8*)(lds + PG8_SA(b, h) + aoff + m * 2048 + k * 1024); } while (0)
#define PG8_LDB(dst, b, h) do { _Pragma("unroll") for (int n = 0; n < 2; ++n) _Pragma("unroll") for (int k = 0; k < 2; ++k) dst[n][k] = *(const LAS bf16x8*)(lds + PG8_SB(b, h) + boff + n * 2048 + k * 1024); } while (0)
#define PG8_MMA(ai, bj, At, Bt) do { __builtin_amdgcn_s_setprio(1); _Pragma("unroll") for (int m = 0; m < 4; ++m) _Pragma("unroll") for (int n = 0; n < 2; ++n) _Pragma("unroll") for (int k = 0; k < 2; ++k) \
        acc[ai][bj][m][n] = __builtin_amdgcn_mfma_f32_16x16x32_bf16(Bt[n][k], At[m][k], acc[ai][bj][m][n], 0, 0, 0); __builtin_amdgcn_s_setprio(0); } while (0)
#define PG8_WAIT_V(n) asm volatile("s_waitcnt vmcnt(" #n ")" ::: "memory")
#define PG8_WAIT_L(n) asm volatile("s_waitcnt lgkmcnt(" #n ")" ::: "memory")
#define PG8_BAR __builtin_amdgcn_s_barrier()
#define PG8_SCHED __builtin_amdgcn_sched_barrier(0)
#define PG8_GOFF(dst, slot) do { if constexpr (GATHER) { _Pragma("unroll") for (int _h = 0; _h < 2; ++_h) _Pragma("unroll") for (int _i = 0; _i < 2; ++_i) { \
        const unsigned _e = rowtab[(slot) * 256 + _h * 128 + RA[_i]]; const unsigned _tok = (_e == 0xFFFFFFFFu) ? 0u : (_e >> 1); dst[_h][_i] = (_tok * (unsigned)g.lda + (unsigned)CA[_i]) * 2u; } } } while (0)
    Unit cur, nxt; int ui = 0;
    if (!S.next(0, cur)) return;
    f32x4 acc[2][2][4][2];
#pragma unroll
    for (int a = 0; a < 2; ++a)
#pragma unroll
        for (int b = 0; b < 2; ++b)
#pragma unroll
            for (int m = 0; m < 4; ++m)
#pragma unroll
                for (int n = 0; n < 2; ++n) acc[a][b][m][n] = (f32x4){0.f, 0.f, 0.f, 0.f};
    bf16x8 At[4][2], B0[2][2], B1[2][2];
    const char* cA = GATHER ? (const char*)g.A : (const char*)g.A + (size_t)cur.pm * tstepA; const char* cB = (const char*)g.Bt + (size_t)cur.pn * tstepB;
    PG8_GOFF(goffC, cur.slot);
    if constexpr (GATHER) { PG8_WAIT_L(0); }
    PG8_STAGE_B(PG8_SB(0, 0), cB); PG8_STAGE_B(PG8_SB(0, 1), cB + hstepB); PG8_STAGE_A(PG8_SA(0, 0), cA, 0, false); PG8_STAGE_A(PG8_SA(0, 1), cA, 1, false);
    if (wr == 1) PG8_BAR;
    PG8_WAIT_V(2); PG8_BAR;
    PG8_STAGE_B(PG8_SB(1, 0), cB + kstep); PG8_STAGE_A(PG8_SA(1, 0), cA + kstep, 0, false); PG8_STAGE_B(PG8_SB(1, 1), cB + hstepB + kstep);
    PG8_WAIT_V(6); PG8_BAR;
    for (;;) {
        const bool has_next = S.next(ui + 1, nxt);
        const char* nA = has_next ? (GATHER ? (const char*)g.A : (const char*)g.A + (size_t)nxt.pm * tstepA) : cA; const char* nB = has_next ? (const char*)g.Bt + (size_t)nxt.pn * tstepB : cB;
        if constexpr (GATHER) { if (has_next) { PG8_GOFF(goffN, nxt.slot); } else { _Pragma("unroll") for (int _h = 0; _h < 2; ++_h) _Pragma("unroll") for (int _i = 0; _i < 2; ++_i) goffN[_h][_i] = goffC[_h][_i]; } }
        for (int t = 0; t < nt; t += 2) {
            const bool last = (t == nt - 2);
            const char* a1 = cA + (size_t)(t + 1) * kstep;
            const char* a2 = last ? nA : cA + (size_t)(t + 2) * kstep; const char* b2 = last ? nB : cB + (size_t)(t + 2) * kstep;
            const char* a3 = a2 + kstep; const char* b3 = b2 + kstep;
            PG8_LDB(B0, 0, 0); PG8_LDB(B1, 0, 1); PG8_SCHED; PG8_LDA(At, 0, 0); PG8_STAGE_A(PG8_SA(1, 1), a1, 1, false);
            PG8_WAIT_V(8); PG8_WAIT_L(0); PG8_BAR; PG8_MMA(0, 0, At, B0); PG8_MMA(0, 1, At, B1); PG8_BAR; PG8_SCHED;
            PG8_LDA(At, 0, 1); PG8_STAGE_B(PG8_SB(0, 0), b2); PG8_STAGE_B(PG8_SB(0, 1), b2 + hstepB); PG8_STAGE_A(PG8_SA(0, 0), a2, 0, last);
            PG8_WAIT_V(8); PG8_WAIT_L(0); PG8_BAR; PG8_MMA(1, 0, At, B0); PG8_MMA(1, 1, At, B1); PG8_BAR; PG8_SCHED;
            PG8_LDB(B0, 1, 0); PG8_LDB(B1, 1, 1); PG8_SCHED; PG8_LDA(At, 1, 0); PG8_STAGE_A(PG8_SA(0, 1), a2, 1, last);
            PG8_WAIT_V(8); PG8_WAIT_L(0); PG8_BAR; PG8_MMA(0, 0, At, B0); PG8_MMA(0, 1, At, B1); PG8_BAR; PG8_SCHED;
            PG8_LDA(At, 1, 1); PG8_STAGE_B(PG8_SB(1, 0), b3); PG8_STAGE_B(PG8_SB(1, 1), b3 + hstepB); PG8_STAGE_A(PG8_SA(1, 0), a3, 0, last);
            PG8_WAIT_V(8); PG8_WAIT_L(0); PG8_BAR; PG8_MMA(1, 0, At, B0); PG8_MMA(1, 1, At, B1); PG8_BAR; PG8_SCHED;
        }
        if (wr == 0) PG8_BAR;
        E(acc, cur, wr, wc, fr, fq);
        if (!has_next) break;
#pragma unroll
        for (int a = 0; a < 2; ++a)
#pragma unroll
            for (int b = 0; b < 2; ++b)
#pragma unroll
                for (int m = 0; m < 4; ++m)
#pragma unroll
                    for (int n = 0; n < 2; ++n) acc[a][b][m][n] = (f32x4){0.f, 0.f, 0.f, 0.f};
        cur = nxt; cA = nA; cB = nB; ++ui;
        if constexpr (GATHER) { _Pragma("unroll") for (int _h = 0; _h < 2; ++_h) _Pragma("unroll") for (int _i = 0; _i < 2; ++_i) goffC[_h][_i] = goffN[_h][_i]; }
        if (wr == 1) PG8_BAR;
    }
    PG8_WAIT_V(0);
    PG8_BAR;
#undef PG8_SA
#undef PG8_SB
#undef PG8_STAGE_A
#undef PG8_STAGE_B
#undef PG8_LDA
#undef PG8_LDB
#undef PG8_MMA
#undef PG8_WAIT_V
#undef PG8_WAIT_L
#undef PG8_BAR
#undef PG8_SCHED
#undef PG8_GOFF
}

typedef f32x4 Acc[2][2][4][2];

__device__ __forceinline__ u32x4 pack8(const f32x4 a, const f32x4 b) { u32x4 w; w.x = pk2(a[0], a[1]); w.y = pk2(a[2], a[3]); w.z = pk2(b[0], b[1]); w.w = pk2(b[2], b[3]); return w; }
__device__ __forceinline__ void unpack8(const u32x4 w, f32x4& a, f32x4& b) { a = (f32x4){bf_lo(w.x), bf_hi(w.x), bf_lo(w.y), bf_hi(w.y)}; b = (f32x4){bf_lo(w.z), bf_hi(w.z), bf_lo(w.w), bf_hi(w.w)}; }

struct EpiProj {
    static constexpr bool PERM = true;
    bf16* P; const float *rac, *ras, *rrc, *rrs;
    __device__ __forceinline__ void operator()(const Acc& acc, const Unit& u, int wr, int wc, int fr, int fq) const {
        const int pn = u.pn; const int row0 = u.pm * BM + wr * 64 + fr;
        if (pn <= 4) {
            const float sc = pn < 4 ? 0.125f : 1.0f;
            const int col1 = 256 * pn + 64 * wc + 8 * fq;
#pragma unroll
            for (int ai = 0; ai < 2; ++ai)
#pragma unroll
                for (int m = 0; m < 4; ++m) { const int row = row0 + ai * HALF + m * 16;
                    const f32x4 c0 = *(const f32x4*)(rac + (size_t)row * 32 + 8 * fq), c1 = *(const f32x4*)(rac + (size_t)row * 32 + 8 * fq + 4);
                    const f32x4 s0 = *(const f32x4*)(ras + (size_t)row * 32 + 8 * fq), s1 = *(const f32x4*)(ras + (size_t)row * 32 + 8 * fq + 4);
                    const f32x4 x10 = acc[ai][0][m][0], x11 = acc[ai][0][m][1], x20 = acc[ai][1][m][0], x21 = acc[ai][1][m][1];
                    const f32x4 o10 = (x10 * c0 - x20 * s0) * sc, o11 = (x11 * c1 - x21 * s1) * sc, o20 = (x20 * c0 + x10 * s0) * sc, o21 = (x21 * c1 + x11 * s1) * sc;
                    bf16* rp = P + (size_t)row * INW + col1;
                    *(u32x4*)rp = pack8(o10, o11); *(u32x4*)(rp + 32) = pack8(o20, o21); }
        } else if (pn >= 6 && pn <= 13) {
            const float sc = pn >= 10 ? 0.08838834764831845f : 1.0f;
            const int j0 = 32 * (wc & 1) + 8 * fq; const int col1 = 256 * pn + 128 * (wc >> 1) + j0;
#pragma unroll
            for (int ai = 0; ai < 2; ++ai)
#pragma unroll
                for (int m = 0; m < 4; ++m) { const int row = row0 + ai * HALF + m * 16;
                    const f32x4 c0 = *(const f32x4*)(rrc + (size_t)row * 64 + j0), c1 = *(const f32x4*)(rrc + (size_t)row * 64 + j0 + 4);
                    const f32x4 s0 = *(const f32x4*)(rrs + (size_t)row * 64 + j0), s1 = *(const f32x4*)(rrs + (size_t)row * 64 + j0 + 4);
                    const f32x4 x10 = acc[ai][0][m][0], x11 = acc[ai][0][m][1], x20 = acc[ai][1][m][0], x21 = acc[ai][1][m][1];
                    const f32x4 o10 = (x10 * c0 - x20 * s0) * sc, o11 = (x11 * c1 - x21 * s1) * sc, o20 = (x20 * c0 + x10 * s0) * sc, o21 = (x21 * c1 + x11 * s1) * sc;
                    bf16* rp = P + (size_t)row * INW + col1;
                    *(u32x4*)rp = pack8(o10, o11); *(u32x4*)(rp + 64) = pack8(o20, o21); }
        } else {
            const int act = pn >= 22 ? 2 : (pn >= 18 ? 1 : 0);
            const int col0 = 256 * pn + 32 * wc + 8 * fq;
#pragma unroll
            for (int ai = 0; ai < 2; ++ai)
#pragma unroll
                for (int m = 0; m < 4; ++m) { bf16* rp = P + (size_t)(row0 + ai * HALF + m * 16) * INW + col0;
#pragma unroll
                    for (int bj = 0; bj < 2; ++bj) { f32x4 v0 = acc[ai][bj][m][0], v1 = acc[ai][bj][m][1];
                        if (act == 1) { _Pragma("unroll") for (int i = 0; i < 4; ++i) { v0[i] = siluf_(v0[i]); v1[i] = siluf_(v1[i]); } }
                        else if (act == 2) { _Pragma("unroll") for (int i = 0; i < 4; ++i) { v0[i] = sigmoidf_(v0[i]); v1[i] = sigmoidf_(v1[i]); } }
                        *(u32x4*)(rp + bj * HALF) = pack8(v0, v1); } }
        }
    }
};
struct EpiT1 {
    static constexpr bool PERM = true;
    bf16* T1; const bf16* P;
    __device__ __forceinline__ void operator()(const Acc& acc, const Unit& u, int wr, int wc, int fr, int fq) const {
        const int row0 = u.pm * BM + wr * 64 + fr, col0 = u.pn * BM + wc * 32 + 8 * fq;
#pragma unroll
        for (int ai = 0; ai < 2; ++ai)
#pragma unroll
            for (int m = 0; m < 4; ++m) { const size_t row = (size_t)(row0 + ai * HALF + m * 16);
#pragma unroll
                for (int bj = 0; bj < 2; ++bj) { const int col = col0 + bj * HALF;
                    f32x4 g0, g1; unpack8(*(const u32x4*)(P + row * INW + C_GA + col), g0, g1);
                    *(u32x4*)(T1 + row * D + col) = pack8(acc[ai][bj][m][0] * g0, acc[ai][bj][m][1] * g1); } }
    }
};
struct EpiMerge {
    static constexpr bool PERM = true;
    bf16* MG; const bf16* T1; const bf16* P;
    __device__ __forceinline__ void operator()(const Acc& acc, const Unit& u, int wr, int wc, int fr, int fq) const {
        const int row0 = u.pm * BM + wr * 64 + fr, col0 = u.pn * BM + wc * 32 + 8 * fq;
#pragma unroll
        for (int ai = 0; ai < 2; ++ai)
#pragma unroll
            for (int m = 0; m < 4; ++m) { const size_t row = (size_t)(row0 + ai * HALF + m * 16);
#pragma unroll
                for (int bj = 0; bj < 2; ++bj) { const int col = col0 + bj * HALF;
                    f32x4 g0, g1, t0, t1; unpack8(*(const u32x4*)(P + row * INW + C_GB + col), g0, g1); unpack8(*(const u32x4*)(T1 + row * D + col), t0, t1);
                    *(u32x4*)(MG + row * D + col) = pack8(t0 + acc[ai][bj][m][0] * g0, t1 + acc[ai][bj][m][1] * g1); } }
    }
};
struct EpiResid {
    static constexpr bool PERM = false;
    const float* xin; float* xout; const float* gate;
    __device__ __forceinline__ void operator()(const Acc& acc, const Unit& u, int wr, int wc, int fr, int fq) const {
        const int row0 = u.pm * BM + wr * 64 + fr, col0 = u.pn * BM + wc * 32 + 4 * fq; const int b = u.pm >> 3;
        f32x4 gv[2][2];
#pragma unroll
        for (int bj = 0; bj < 2; ++bj)
#pragma unroll
            for (int n = 0; n < 2; ++n) gv[bj][n] = *(const f32x4*)(gate + (size_t)b * 12288 + col0 + bj * HALF + n * 16);
#pragma unroll
        for (int ai = 0; ai < 2; ++ai)
#pragma unroll
            for (int m = 0; m < 4; ++m) { const size_t off = (size_t)(row0 + ai * HALF + m * 16) * D + col0;
#pragma unroll
                for (int bj = 0; bj < 2; ++bj)
#pragma unroll
                    for (int n = 0; n < 2; ++n) { const f32x4 xi = *(const f32x4*)(xin + off + bj * HALF + n * 16);
                        *(f32x4*)(xout + off + bj * HALF + n * 16) = xi + gv[bj][n] * acc[ai][bj][m][n]; } }
    }
};
struct EpiGU {
    static constexpr bool PERM = true;
    bf16* ACT;
    __device__ __forceinline__ void operator()(const Acc& acc, const Unit& u, int wr, int wc, int fr, int fq) const {
        const int row0 = u.pm * BM + wr * 64 + fr, col0 = (u.pn & 7) * 128 + wc * 32 + 8 * fq;
#pragma unroll
        for (int ai = 0; ai < 2; ++ai)
#pragma unroll
            for (int m = 0; m < 4; ++m) { f32x4 g0 = acc[ai][0][m][0], g1 = acc[ai][0][m][1]; const f32x4 u0 = acc[ai][1][m][0], u1 = acc[ai][1][m][1];
#pragma unroll
                for (int i = 0; i < 4; ++i) { g0[i] = siluf_(g0[i]) * u0[i]; g1[i] = siluf_(g1[i]) * u1[i]; }
                *(u32x4*)(ACT + (size_t)(row0 + ai * HALF + m * 16) * DFF + col0) = pack8(g0, g1); }
    }
};
struct EpiDown {
    static constexpr bool PERM = true;
    bf16* Y; const LAS unsigned* rowtab;
    __device__ __forceinline__ void operator()(const Acc& acc, const Unit& u, int wr, int wc, int fr, int fq) const {
        const int col0 = (u.pn & 7) * BM + wc * 32 + 8 * fq;
#pragma unroll
        for (int ai = 0; ai < 2; ++ai)
#pragma unroll
            for (int m = 0; m < 4; ++m) { const unsigned e = rowtab[u.slot * 256 + ai * HALF + wr * 64 + m * 16 + fr];
                if (e != 0xFFFFFFFFu) { bf16* rp = Y + (size_t)e * D + col0;
#pragma unroll
                    for (int bj = 0; bj < 2; ++bj) *(u32x4*)(rp + bj * HALF) = pack8(acc[ai][bj][m][0], acc[ai][bj][m][1]); } }
    }
};
}

struct Args { const void* in[19]; float* out; unsigned char* ws; int ph_lo, ph_hi; };

__device__ __forceinline__ bf16x8 mk8(u32x2 lo, u32x2 hi) { u32x4 w = {lo.x, lo.y, hi.x, hi.y}; return __builtin_bit_cast(bf16x8, w); }
__device__ __forceinline__ bf16x8 packf8(const f32x16& s, int base) {
    u32x4 w; w.x = pk2(s[base + 0], s[base + 1]); w.y = pk2(s[base + 2], s[base + 3]); w.z = pk2(s[base + 4], s[base + 5]); w.w = pk2(s[base + 6], s[base + 7]);
    return __builtin_bit_cast(bf16x8, w);
}
#define MFMA32(a, b, c) __builtin_amdgcn_mfma_f32_32x32x16_bf16((a), (b), (c), 0, 0, 0)

__device__ __forceinline__ int dst_row_map(int mode, int n) {
    if (mode == 1) { const int pn = n >> 8, u = n & 255;
        if (pn <= 4) return 256 * pn + 128 * ((u >> 5) & 1) + 32 * (u >> 6) + (u & 31);
        if (pn >= 6 && pn <= 13) return 256 * pn + 128 * ((u >> 6) & 1) + 64 * (u >> 7) + (u & 63);
        return n; }
    if (mode == 2) return (n >> 7) * 256 + (n & 127);
    if (mode == 3) return (n >> 7) * 256 + 128 + (n & 127);
    return n;
}
__device__ __forceinline__ void conv_item(const float* W, int N, bf16* WT, int ldk, int kb, int nb, int mode, LAS unsigned* scr, int lane) {
    const int k0 = kb * 64, n0 = nb * 64, kp = lane >> 4, nq = lane & 15;
    f32x4 v[16];
#pragma unroll
    for (int p = 0; p < 8; ++p) { const float* src = W + (size_t)(k0 + 8 * p + 2 * kp) * N + n0 + 4 * nq;
        v[2 * p] = *(const f32x4*)src; v[2 * p + 1] = *(const f32x4*)(src + N); }
#pragma unroll
    for (int p = 0; p < 8; ++p)
#pragma unroll
        for (int j = 0; j < 4; ++j) scr[(4 * nq + j) * 33 + 4 * p + kp] = pk2(v[2 * p][j], v[2 * p + 1][j]);
    asm volatile("s_waitcnt lgkmcnt(0)" ::: "memory");
#pragma unroll
    for (int q = 0; q < 8; ++q) { const int n = 8 * q + (lane >> 3), c = lane & 7;
        u32x4 o; o.x = scr[n * 33 + 4 * c]; o.y = scr[n * 33 + 4 * c + 1]; o.z = scr[n * 33 + 4 * c + 2]; o.w = scr[n * 33 + 4 * c + 3];
        *(u32x4*)(WT + (size_t)dst_row_map(mode, n0 + n) * ldk + k0 + 8 * c) = o; }
    asm volatile("s_waitcnt lgkmcnt(0)" ::: "memory");
}

constexpr int IT_IN = 32 * 152, IT_A = 16 * 32, IT_O = 32 * 32, IT_G = 512, IT_LAYER = IT_IN + 2 * IT_A + IT_O + 3 * 16 * IT_G;
constexpr int IT_GEMV = 96 * 16;
constexpr int IT_TOTAL = IT_GEMV + 2 * IT_LAYER;

__global__ void __launch_bounds__(512, 2) fwd_kernel(Args args) {
    extern __shared__ __attribute__((aligned(16))) unsigned char lds_raw[];
    LAS unsigned char* lds = (LAS unsigned char*)lds_raw;
    const int wave0 = __builtin_amdgcn_readfirstlane((int)threadIdx.x >> 6);
    const int G = gridDim.x, bid = blockIdx.x;
    const int NGW = G * 8;
#define PHASE_IDS() int lane; asm volatile("v_mbcnt_lo_u32_b32 %0, -1, 0\n\tv_mbcnt_hi_u32_b32 %0, -1, %0" : "=v"(lane)); int wave = wave0; asm volatile("" : "+s"(wave)); \
    const int tid = wave * 64 + lane; const int gw = bid * 8 + wave; (void)gw
    volatile LAS unsigned* MISC = (volatile LAS unsigned*)(lds + MISC_OFF);
    LAS int* moe = (LAS int*)(lds + MOE_OFF);
    LAS unsigned* rowtab = (LAS unsigned*)(lds + TAB_OFF);
    const unsigned long long kargs = (unsigned long long)__builtin_amdgcn_kernarg_segment_ptr();
#define LDARG(off) ({ unsigned long long _r; asm volatile("s_load_dwordx2 %0, %1, %2\n\ts_waitcnt lgkmcnt(0)" : "=s"(_r) : "s"(kargs), "i"(off) : "memory"); _r; })
#define INP(k) ((const float*)LDARG(8 * (k)))
#define WSP() ((unsigned char*)LDARG(160))
#define OUTP() ((float*)LDARG(152))
    for (int u = threadIdx.x; u < (LDS_BYTES - LDSCTL_OFF) / 4; u += 512) ((LAS unsigned*)(lds + LDSCTL_OFF))[u] = 0u;
    __syncthreads();
#if MK_ONE_LAUNCH
    XcdBarrier bar = xcd_barrier_post((unsigned*)(WSP() + WS_CTL) + CW_BAR, MISC);
#define GRID_BAR() xcd_barrier(bar)
#else
#define GRID_BAR() do {} while (0)
#endif
    const int lo = args.ph_lo, hi = args.ph_hi;
#ifndef ONLY_PHASE
#define ONLY_PHASE -1
#endif
#define PEN(id) (ONLY_PHASE < 0 || ONLY_PHASE == (id))
#define IN(k) (lo <= (k) && (k) < hi)
#define SEAM(k) do { if (IN(k) && IN((k) + 1)) GRID_BAR(); } while (0)

    if (PEN(0) && IN(0)) {
        PHASE_IDS();
        LAS unsigned* scr = (LAS unsigned*)(lds + wave * 8704);
        unsigned char* ws = WSP(); const float* c_in = INP(1); const float* w_ada = INP(3); float* MODP = (float*)(ws + WS_MODP);
        for (int it = gw; it < IT_TOTAL; it += NGW) {
            if (it < IT_GEMV) {
                const int kc = it / 96, cg = it % 96, l = cg / 48, col0 = (cg % 48) * 256 + 4 * lane;
                LAS float* sc = (LAS float*)scr;
#pragma unroll
                for (int b = 0; b < 4; ++b)
#pragma unroll
                    for (int i = 0; i < 2; ++i) { const float cv = c_in[b * D + 128 * kc + lane + 64 * i]; sc[b * 128 + lane + 64 * i] = siluf_(cv); }
                asm volatile("s_waitcnt lgkmcnt(0)" ::: "memory");
                const float* W = w_ada + ((size_t)l * D + 128 * kc) * 12288 + col0;
                f32x4 a0 = {0.f, 0.f, 0.f, 0.f}, a1 = a0, a2 = a0, a3 = a0;
#pragma unroll 8
                for (int kk = 0; kk < 128; ++kk) { const f32x4 w = *(const f32x4*)(W + (size_t)kk * 12288);
                    a0 += sc[kk] * w; a1 += sc[128 + kk] * w; a2 += sc[256 + kk] * w; a3 += sc[384 + kk] * w; }
                float* o = MODP + (size_t)((kc * 2 + l) * 4) * 12288 + col0;
                *(f32x4*)(o) = a0; *(f32x4*)(o + 12288) = a1; *(f32x4*)(o + 2 * 12288) = a2; *(f32x4*)(o + 3 * 12288) = a3;
                asm volatile("s_waitcnt lgkmcnt(0)" ::: "memory");
            } else {
                int r = it - IT_GEMV; const int l = r / IT_LAYER; r -= l * IT_LAYER;
                bf16* WL = (bf16*)(ws + WS_W + (size_t)l * WL_STRIDE);
                if (r < IT_IN) { conv_item(INP(7) + (size_t)l * D * INW, INW, (bf16*)((unsigned char*)WL + WL_IN), D, r / 152, r % 152, 1, scr, lane); continue; } r -= IT_IN;
                if (r < IT_A) { conv_item(INP(9) + (size_t)l * 1024 * D, D, (bf16*)((unsigned char*)WL + WL_A), 1024, r / 32, r % 32, 0, scr, lane); continue; } r -= IT_A;
                if (r < IT_A) { conv_item(INP(11) + (size_t)l * 1024 * D, D, (bf16*)((unsigned char*)WL + WL_R), 1024, r / 32, r % 32, 0, scr, lane); continue; } r -= IT_A;
                if (r < IT_O) { conv_item(INP(12) + (size_t)l * D * D, D, (bf16*)((unsigned char*)WL + WL_O), D, r / 32, r % 32, 0, scr, lane); continue; } r -= IT_O;
                if (r < 16 * IT_G) { const int e = r / IT_G, q = r % IT_G; conv_item(INP(15) + (size_t)(l * 16 + e) * D * DFF, DFF, (bf16*)((unsigned char*)WL + WL_GU) + (size_t)e * 2048 * D, D, q / 16, q % 16, 2, scr, lane); continue; } r -= 16 * IT_G;
                if (r < 16 * IT_G) { const int e = r / IT_G, q = r % IT_G; conv_item(INP(16) + (size_t)(l * 16 + e) * D * DFF, DFF, (bf16*)((unsigned char*)WL + WL_GU) + (size_t)e * 2048 * D, D, q / 16, q % 16, 3, scr, lane); continue; } r -= 16 * IT_G;
                { const int e = r / IT_G, q = r % IT_G; conv_item(INP(17) + (size_t)(l * 16 + e) * DFF * D, D, (bf16*)((unsigned char*)WL + WL_D) + (size_t)e * D * DFF, DFF, q / 32, q % 32, 0, scr, lane); }
            }
        }
    }
    SEAM(0);
    if (PEN(1) && IN(1)) {
        PHASE_IDS();
        const int gt = bid * 512 + tid, NT = G * 512;
        unsigned char* ws = WSP(); const float* b_ada = INP(4); const int* pos_in = (const int*)INP(2);
        const float* MODP = (const float*)(ws + WS_MODP); float* MOD = (float*)(ws + WS_MOD);
        float* ROPA_C = (float*)(ws + WS_ROPA_C); float* ROPA_S = (float*)(ws + WS_ROPA_S); float* ROPR_C = (float*)(ws + WS_ROPR_C); float* ROPR_S = (float*)(ws + WS_ROPR_S);
        for (int i = gt; i < 2 * 4 * 12288; i += NT) { const int l = i / 49152, col = i % 12288;
            float s = b_ada[l * 12288 + col];
#pragma unroll
            for (int kc = 0; kc < 16; ++kc) s += MODP[(size_t)kc * 98304 + i];
            MOD[i] = s; }
        for (int i = gt; i < T * 96; i += NT) { const int tok = i / 96, jj = i % 96; const bool isA = jj < 32; const int j = isA ? jj : jj - 32;
            const float ex = isA ? (float)j * (2.0f / 64.0f) : (float)j * (2.0f / 128.0f);
            const float inv = fexp2(-ex * 13.287712379549449f);
            const double ang = (double)pos_in[tok] * (double)inv;
            const double rev = ang * 0.15915494309189535; const double fr_ = rev - __builtin_rint(rev);
            const float f = (float)fr_; const float sn = __builtin_amdgcn_sinf(f), cs = __builtin_amdgcn_cosf(f);
            if (isA) { ROPA_C[tok * 32 + j] = cs; ROPA_S[tok * 32 + j] = sn; } else { ROPR_C[tok * 64 + j] = cs; ROPR_S[tok * 64 + j] = sn; } }
    }
    SEAM(1);

#define WLP(ws_, off) ((const bf16*)((ws_) + WS_W + (size_t)l * WL_STRIDE + (off)))
#pragma unroll 1
    for (int l = 0; l < DEPTH; ++l) {
        const int pb = 2 + 9 * l;
        if (PEN(2) && IN(pb + 0)) {
            PHASE_IDS();
            unsigned char* ws = WSP(); const float* x_in = INP(0); const float* norm1_g = INP(5);
            const float* MOD = (const float*)(ws + WS_MOD); const float* modl = MOD + (size_t)l * 4 * 12288; const float* XA = (const float*)(ws + WS_XA); float* XB = (float*)(ws + WS_XB);
            const bf16* YBUF = (const bf16*)(ws + WS_YBUF); bf16* Hb = (bf16*)(ws + WS_H);
            for (int row = gw; row < T; row += NGW) {
                const int b = row >> 11;
                f32x4 v[8];
                if (l == 0) {
#pragma unroll
                    for (int j = 0; j < 8; ++j) v[j] = *(const f32x4*)(x_in + (size_t)row * D + 4 * lane + 256 * j);
                } else {
                    const float* twp = (const float*)(ws + WS_TW) + (size_t)(l - 1) * T * 2; const float w0 = twp[row * 2], w1 = twp[row * 2 + 1];
                    const float* g2 = MOD + (size_t)((l - 1) * 4 + b) * 12288 + 5 * 2048;
#pragma unroll
                    for (int j = 0; j < 8; ++j) { const int col = 4 * lane + 256 * j;
                        const f32x4 xv = *(const f32x4*)(XA + (size_t)row * D + col); const f32x4 gv = *(const f32x4*)(g2 + col);
                        const u32x2 y0 = *(const u32x2*)(YBUF + (size_t)(row * 2) * D + col), y1 = *(const u32x2*)(YBUF + (size_t)(row * 2 + 1) * D + col);
                        f32x4 mo; mo[0] = w0 * bf_lo(y0.x) + w1 * bf_lo(y1.x); mo[1] = w0 * bf_hi(y0.x) + w1 * bf_hi(y1.x); mo[2] = w0 * bf_lo(y0.y) + w1 * bf_lo(y1.y); mo[3] = w0 * bf_hi(y0.y) + w1 * bf_hi(y1.y);
                        v[j] = xv + gv * mo; *(f32x4*)(XB + (size_t)row * D + col) = v[j]; }
                }
                float ss = 0.f;
#pragma unroll
                for (int j = 0; j < 8; ++j) ss += (v[j][0] * v[j][0] + v[j][1] * v[j][1]) + (v[j][2] * v[j][2] + v[j][3] * v[j][3]);
                const float rstd = 1.0f / sqrtf(wave_sum(ss) * (1.0f / D) + EPS);
                const float* sh = modl + (size_t)b * 12288, *scl = sh + 2048;
#pragma unroll
                for (int j = 0; j < 8; ++j) { const int col = 4 * lane + 256 * j;
                    const f32x4 gg = *(const f32x4*)(norm1_g + l * D + col), s1 = *(const f32x4*)(scl + col), h1 = *(const f32x4*)(sh + col);
                    const f32x4 o = v[j] * rstd * gg * (s1 + 1.0f) + h1;
                    u32x2 w; w.x = pk2(o[0], o[1]); w.y = pk2(o[2], o[3]); *(u32x2*)(Hb + (size_t)row * D + col) = w; }
            }
        }
        SEAM(pb + 0);
        if (PEN(3) && IN(pb + 1)) {
            PHASE_IDS();
            unsigned char* ws = WSP();
            pg8::Gemm g{(const bf16*)(ws + WS_H), WLP(ws, WL_IN), D, D, D}; pg8::StaticOrder S; S.init(T, INW, G, bid);
            pg8::EpiProj E{(bf16*)(ws + WS_PROJ), (const float*)(ws + WS_ROPA_C), (const float*)(ws + WS_ROPA_S), (const float*)(ws + WS_ROPR_C), (const float*)(ws + WS_ROPR_S)};
            pg8::gemm_phase<pg8::EpiProj, pg8::StaticOrder, false>(tid, lds, g, S, E, rowtab);
        }
        SEAM(pb + 1);
        if (PEN(4) && IN(pb + 2)) {
            PHASE_IDS();
            const int l31 = lane & 31, hh = lane >> 5;
            unsigned char* ws = WSP(); const float* sinks = INP(8); const bf16* PROJ = (const bf16*)(ws + WS_PROJ); bf16* AO = (bf16*)(ws + WS_AO); float* KV = (float*)(ws + WS_KV);
            for (int un = bid; un < 256; un += G) {
                const int b = un >> 6, n = (un >> 2) & 15, hk = un & 3;
                const int tokc = b * SEQ + n * 128;
                LAS unsigned char* Ks = lds; LAS unsigned char* Vt = lds + 36864;
#pragma unroll
                for (int it = 0; it < 4; ++it) { const int idx = tid + 512 * it, j = idx >> 3, c = idx & 7;
                    const bool valid = (n > 0) || (j >= 128); const size_t tok = (size_t)(tokc - 128 + j);
                    u32x4 kv = {0u, 0u, 0u, 0u}, vv = {0u, 0u, 0u, 0u};
                    if (valid) { kv = *(const u32x4*)(PROJ + tok * INW + C_KA + hk * 64 + 8 * c); vv = *(const u32x4*)(PROJ + tok * INW + C_VA + hk * 64 + 8 * c); }
                    *(LAS u32x4*)(Ks + j * 144 + c * 16) = kv;
                    LAS bf16* vt = (LAS bf16*)Vt;
                    vt[(8 * c + 0) * 264 + j] = (bf16)(vv.x & 0xffff); vt[(8 * c + 1) * 264 + j] = (bf16)(vv.x >> 16);
                    vt[(8 * c + 2) * 264 + j] = (bf16)(vv.y & 0xffff); vt[(8 * c + 3) * 264 + j] = (bf16)(vv.y >> 16);
                    vt[(8 * c + 4) * 264 + j] = (bf16)(vv.z & 0xffff); vt[(8 * c + 5) * 264 + j] = (bf16)(vv.z >> 16);
                    vt[(8 * c + 6) * 264 + j] = (bf16)(vv.w & 0xffff); vt[(8 * c + 7) * 264 + j] = (bf16)(vv.w >> 16); }
                __syncthreads();
#pragma unroll 1
                for (int t2 = 0; t2 < 2; ++t2) {
                    const int id = wave + 8 * t2, gq = id & 3, qb = id >> 2, head = hk * 4 + gq;
                    const size_t tok = (size_t)(tokc + 32 * qb + l31);
                    bf16x8 qf[4];
#pragma unroll
                    for (int ks = 0; ks < 4; ++ks) qf[ks] = *(const bf16x8*)(PROJ + tok * INW + C_QA + head * 64 + 16 * ks + 8 * hh);
                    f32x16 sT[5];
#pragma unroll
                    for (int k5 = 0; k5 < 5; ++k5) { f32x16 s = {};
#pragma unroll
                        for (int ks = 0; ks < 4; ++ks) { const bf16x8 a = *(const LAS bf16x8*)(Ks + (32 * (qb + k5) + l31) * 144 + (16 * ks + 8 * hh) * 2); s = MFMA32(a, qf[ks], s); }
                        sT[k5] = s; }
                    const float sink = sinks[l * 16 + head];
                    float mx = sink;
#pragma unroll
                    for (int k5 = 0; k5 < 5; ++k5)
#pragma unroll
                        for (int r = 0; r < 16; ++r) { const int jj = crow(r, hh); const int rel = 32 * k5 + jj - l31;
                            const bool valid = (rel >= 1) && (rel <= 128) && ((n > 0) || (32 * (qb + k5) + jj >= 128));
                            const float sv = valid ? sT[k5][r] : -INFINITY; sT[k5][r] = sv; mx = fmaxf(mx, sv); }
                    mx = fmaxf(mx, __shfl_xor(mx, 32));
                    float lsum = 0.f;
#pragma unroll
                    for (int k5 = 0; k5 < 5; ++k5)
#pragma unroll
                        for (int r = 0; r < 16; ++r) { const float p = fexp2((sT[k5][r] - mx) * LOG2E); sT[k5][r] = p; lsum += p; }
                    lsum += __shfl_xor(lsum, 32);
                    lsum += fexp2((sink - mx) * LOG2E);
                    f32x16 oT[2] = {};
#pragma unroll
                    for (int k5 = 0; k5 < 5; ++k5)
#pragma unroll
                        for (int s2 = 0; s2 < 2; ++s2) { const bf16x8 pbf = packf8(sT[k5], 8 * s2);
#pragma unroll
                            for (int db = 0; db < 2; ++db) { const LAS unsigned char* vp = Vt + (32 * db + l31) * 528 + (32 * (qb + k5) + 16 * s2 + 4 * hh) * 2;
                                const bf16x8 a = mk8(*(const LAS u32x2*)vp, *(const LAS u32x2*)(vp + 16)); oT[db] = MFMA32(a, pbf, oT[db]); } }
                    const float inv = 1.0f / lsum;
#pragma unroll
                    for (int db = 0; db < 2; ++db)
#pragma unroll
                        for (int g4 = 0; g4 < 4; ++g4) { u32x2 w; w.x = pk2(oT[db][4 * g4] * inv, oT[db][4 * g4 + 1] * inv); w.y = pk2(oT[db][4 * g4 + 2] * inv, oT[db][4 * g4 + 3] * inv);
                            *(u32x2*)(AO + tok * 2048 + head * 64 + 32 * db + 8 * g4 + 4 * hh) = w; }
                }
                __syncthreads();
            }
            for (int un = bid; un < 512; un += G) {
                const int b = un >> 7, h = (un >> 4) & 7, n = un & 15;
                const size_t tok0 = (size_t)(b * SEQ + n * 128);
                const double xg = __builtin_ldexp(1.0, -5 - h);
                const float lg2 = (float)(-(xg + xg * xg * 0.5 + xg * xg * xg * (1.0 / 3.0) + xg * xg * xg * xg * 0.25 + xg * xg * xg * xg * xg * 0.2 + xg * xg * xg * xg * xg * xg * (1.0 / 6.0)) * 1.4426950408889634);
                LAS bf16* Vt = (LAS bf16*)lds; LAS bf16* Kt = (LAS bf16*)(lds + 34816);
#pragma unroll
                for (int it = 0; it < 4; ++it) { const int idx = tid + 512 * it, j = idx >> 4, c = idx & 15;
                    const u32x4 kv = *(const u32x4*)(PROJ + (tok0 + j) * INW + C_KR + h * 128 + 8 * c), vv = *(const u32x4*)(PROJ + (tok0 + j) * INW + C_VR + h * 128 + 8 * c);
                    const float dk = fexp2((float)(127 - j) * lg2);
                    const unsigned kw[4] = {kv.x, kv.y, kv.z, kv.w}, vw[4] = {vv.x, vv.y, vv.z, vv.w};
#pragma unroll
                    for (int i = 0; i < 4; ++i) { const unsigned kk = pk2(bf_lo(kw[i]) * dk, bf_hi(kw[i]) * dk);
                        Kt[(8 * c + 2 * i) * 136 + j] = (bf16)(kk & 0xffff); Kt[(8 * c + 2 * i + 1) * 136 + j] = (bf16)(kk >> 16);
                        Vt[(8 * c + 2 * i) * 136 + j] = (bf16)(vw[i] & 0xffff); Vt[(8 * c + 2 * i + 1) * 136 + j] = (bf16)(vw[i] >> 16); } }
                __syncthreads();
                { const int eb = wave & 3, dh = wave >> 2; f32x16 acc2[2] = {};
#pragma unroll
                    for (int ks = 0; ks < 8; ++ks) { const bf16x8 a = *(const LAS bf16x8*)((LAS unsigned char*)Vt + (32 * eb + l31) * 272 + (16 * ks + 8 * hh) * 2);
#pragma unroll
                        for (int d2 = 0; d2 < 2; ++d2) { const bf16x8 bb = *(const LAS bf16x8*)((LAS unsigned char*)Kt + (64 * dh + 32 * d2 + l31) * 272 + (16 * ks + 8 * hh) * 2); acc2[d2] = MFMA32(a, bb, acc2[d2]); } }
                    float* kvo = KV + (size_t)un * 16384;
#pragma unroll
                    for (int d2 = 0; d2 < 2; ++d2)
#pragma unroll
                        for (int r = 0; r < 16; ++r) kvo[(32 * eb + crow(r, hh)) * 128 + 64 * dh + 32 * d2 + l31] = acc2[d2][r]; }
                __syncthreads();
            }
        }
        SEAM(pb + 2);
        if (PEN(5) && IN(pb + 3)) {
            PHASE_IDS();
            const int l31 = lane & 31, hh = lane >> 5;
            unsigned char* ws = WSP(); const float* ret_norm_g = INP(10); const bf16* PROJ = (const bf16*)(ws + WS_PROJ); bf16* AO = (bf16*)(ws + WS_AO); const float* KV = (const float*)(ws + WS_KV);
            for (int i = bid; i < 512; i += G) {
                const int bh = i & 31, q = i >> 5, n = q < 8 ? q : 23 - q, b = bh >> 3, h = bh & 7;
                const size_t tok0 = (size_t)(b * SEQ + n * 128);
                const double xg = __builtin_ldexp(1.0, -5 - h);
                const float lg2 = (float)(-(xg + xg * xg * 0.5 + xg * xg * xg * (1.0 / 3.0) + xg * xg * xg * xg * 0.25 + xg * xg * xg * xg * xg * 0.2 + xg * xg * xg * xg * xg * xg * (1.0 / 6.0)) * 1.4426950408889634);
                LAS unsigned char* Ks = lds; LAS unsigned char* Vt = lds + 34816; LAS unsigned char* St = lds + 69632; LAS float* red = (LAS float*)(lds + 104448);
#pragma unroll
                for (int it = 0; it < 4; ++it) { const int idx = tid + 512 * it, j = idx >> 4, c = idx & 15;
                    const u32x4 kv = *(const u32x4*)(PROJ + (tok0 + j) * INW + C_KR + h * 128 + 8 * c), vv = *(const u32x4*)(PROJ + (tok0 + j) * INW + C_VR + h * 128 + 8 * c);
                    *(LAS u32x4*)(Ks + j * 272 + c * 16) = kv;
                    LAS bf16* vt = (LAS bf16*)Vt; const unsigned vw[4] = {vv.x, vv.y, vv.z, vv.w};
#pragma unroll
                    for (int i2 = 0; i2 < 4; ++i2) { vt[(8 * c + 2 * i2) * 136 + j] = (bf16)(vw[i2] & 0xffff); vt[(8 * c + 2 * i2 + 1) * 136 + j] = (bf16)(vw[i2] >> 16); } }
                {
                    const float g128 = fexp2(128.0f * lg2);
                    f32x4 sa[8];
#pragma unroll
                    for (int it = 0; it < 8; ++it) sa[it] = (f32x4){0.f, 0.f, 0.f, 0.f};
                    const float* kvb = KV + (size_t)((b * 8 + h) * 16) * 16384;
                    for (int m = 0; m < n; ++m) {
#pragma unroll
                        for (int it = 0; it < 8; ++it) { const int idx = tid + 512 * it; sa[it] = sa[it] * g128 + *(const f32x4*)(kvb + (size_t)m * 16384 + idx * 4); } }
#pragma unroll
                    for (int it = 0; it < 8; ++it) { const int idx = tid + 512 * it, e = idx >> 5, d4 = (idx & 31) * 4; u32x2 w; w.x = pk2(sa[it][0], sa[it][1]); w.y = pk2(sa[it][2], sa[it][3]);
                        *(LAS u32x2*)(St + e * 272 + d4 * 2) = w; } }
                __syncthreads();
                const int ib = wave & 3, eh = wave >> 2, iloc = 32 * ib + l31;
                bf16x8 qf[8];
#pragma unroll
                for (int ks = 0; ks < 8; ++ks) qf[ks] = *(const bf16x8*)(PROJ + (tok0 + iloc) * INW + C_QR + h * 128 + 16 * ks + 8 * hh);
                f32x16 cT[2] = {};
                if (n > 0) {
#pragma unroll
                    for (int e2 = 0; e2 < 2; ++e2)
#pragma unroll
                        for (int ks = 0; ks < 8; ++ks) { const bf16x8 a = *(const LAS bf16x8*)(St + (64 * eh + 32 * e2 + l31) * 272 + (16 * ks + 8 * hh) * 2); cT[e2] = MFMA32(a, qf[ks], cT[e2]); } }
                f32x16 yT[2] = {};
#pragma unroll
                for (int jb = 0; jb < 4; ++jb) if (jb <= ib) {
                    f32x16 s = {};
#pragma unroll
                    for (int ks = 0; ks < 8; ++ks) { const bf16x8 a = *(const LAS bf16x8*)(Ks + (32 * jb + l31) * 272 + (16 * ks + 8 * hh) * 2); s = MFMA32(a, qf[ks], s); }
#pragma unroll
                    for (int r = 0; r < 16; ++r) { const int df = iloc - (32 * jb + crow(r, hh)); s[r] = df >= 0 ? s[r] * fexp2((float)df * lg2) : 0.f; }
#pragma unroll
                    for (int s2 = 0; s2 < 2; ++s2) { const bf16x8 pbf = packf8(s, 8 * s2);
#pragma unroll
                        for (int e2 = 0; e2 < 2; ++e2) { const LAS unsigned char* vp = Vt + (64 * eh + 32 * e2 + l31) * 272 + (32 * jb + 16 * s2 + 4 * hh) * 2;
                            const bf16x8 a = mk8(*(const LAS u32x2*)vp, *(const LAS u32x2*)(vp + 16)); yT[e2] = MFMA32(a, pbf, yT[e2]); } }
                }
                const float qd = fexp2((float)(iloc + 1) * lg2);
                float ss = 0.f;
#pragma unroll
                for (int e2 = 0; e2 < 2; ++e2)
#pragma unroll
                    for (int r = 0; r < 16; ++r) { const float y = yT[e2][r] + qd * cT[e2][r]; yT[e2][r] = y; ss += y * y; }
                ss += __shfl_xor(ss, 32);
                if (hh == 0) red[eh * 128 + iloc] = ss;
                __syncthreads();
                const float rstd = 1.0f / sqrtf((red[iloc] + red[128 + iloc]) * (1.0f / 128.0f) + EPS);
#pragma unroll
                for (int e2 = 0; e2 < 2; ++e2)
#pragma unroll
                    for (int g4 = 0; g4 < 4; ++g4) { const int col = h * 128 + 64 * eh + 32 * e2 + 8 * g4 + 4 * hh;
                        const f32x4 gn = *(const f32x4*)(ret_norm_g + l * 1024 + col); const u32x2 gr = *(const u32x2*)(PROJ + (tok0 + iloc) * INW + C_GR + col);
                        u32x2 w; w.x = pk2(yT[e2][4 * g4] * rstd * gn[0] * bf_lo(gr.x), yT[e2][4 * g4 + 1] * rstd * gn[1] * bf_hi(gr.x));
                        w.y = pk2(yT[e2][4 * g4 + 2] * rstd * gn[2] * bf_lo(gr.y), yT[e2][4 * g4 + 3] * rstd * gn[3] * bf_hi(gr.y));
                        *(u32x2*)(AO + (tok0 + iloc) * 2048 + 1024 + col) = w; }
                __syncthreads();
            }
        }
        SEAM(pb + 3);
        if (PEN(6) && IN(pb + 4)) {
            PHASE_IDS();
            unsigned char* ws = WSP(); const bf16* AO = (const bf16*)(ws + WS_AO); bf16* T1 = (bf16*)(ws + WS_T1); bf16* MG = (bf16*)(ws + WS_MG); const bf16* PROJ = (const bf16*)(ws + WS_PROJ);
            const bf16* Wa_t = WLP(ws, WL_A); const bf16* Wr_t = WLP(ws, WL_R);
            pg8::StaticOrder S; S.init(T, D, G, bid);
            { pg8::Gemm g{AO, Wa_t, 2048, 1024, 1024}; pg8::EpiT1 E{T1, PROJ}; pg8::gemm_phase<pg8::EpiT1, pg8::StaticOrder, false>(tid, lds, g, S, E, rowtab); }
            { pg8::Gemm g{AO + 1024, Wr_t, 2048, 1024, 1024}; pg8::EpiMerge E{MG, T1, PROJ}; pg8::gemm_phase<pg8::EpiMerge, pg8::StaticOrder, false>(tid, lds, g, S, E, rowtab); }
        }
        SEAM(pb + 4);
        if (PEN(7) && IN(pb + 5)) {
            PHASE_IDS();
            unsigned char* ws = WSP(); const float* xcur = (l == 0) ? INP(0) : (const float*)(ws + WS_XB);
            pg8::Gemm g{(const bf16*)(ws + WS_MG), WLP(ws, WL_O), D, D, D}; pg8::StaticOrder S; S.init(T, D, G, bid);
            pg8::EpiResid E{xcur, (float*)(ws + WS_XA), (const float*)(ws + WS_MOD) + (size_t)l * 4 * 12288 + 2 * 2048};
            pg8::gemm_phase<pg8::EpiResid, pg8::StaticOrder, false>(tid, lds, g, S, E, rowtab);
        }
        SEAM(pb + 5);
        if (PEN(8) && IN(pb + 6)) {
            PHASE_IDS();
            unsigned char* ws = WSP(); const float* w_router = INP(13); const float* b_router = INP(14); const float* norm2_g = INP(6);
            const float* XA = (const float*)(ws + WS_XA); bf16* Hb = (bf16*)(ws + WS_H); const float* modl = (const float*)(ws + WS_MOD) + (size_t)l * 4 * 12288;
            unsigned* listl = (unsigned*)(ws + WS_LIST) + (size_t)l * 16 * 8192; float* twl = (float*)(ws + WS_TW) + (size_t)l * T * 2; gu32* gcnt = (gu32*)(ws + WS_CTL) + CW_CNT + l * 16 * 64;
            LAS float* wT = (LAS float*)lds;
#pragma unroll
            for (int it = 0; it < 16; ++it) { const int idx = tid + 512 * it, c = idx >> 2, e4 = idx & 3; const f32x4 w = *(const f32x4*)(w_router + (size_t)c * 16 + 4 * e4);
                wT[(4 * e4 + 0) * 2048 + c] = w[0]; wT[(4 * e4 + 1) * 2048 + c] = w[1]; wT[(4 * e4 + 2) * 2048 + c] = w[2]; wT[(4 * e4 + 3) * 2048 + c] = w[3]; }
            LAS int* lcnt = moe + 40; LAS int* lbase = moe + 56;
            if (tid < 16) lcnt[tid] = 0;
            __syncthreads();
            for (int base = 0; base < T; base += NGW * 2) {
                const int row0 = base + gw * 2; const bool act = row0 < T;
                int pe[4] = {0, 0, 0, 0}; int prank[4] = {0, 0, 0, 0}; float pw[4] = {0.f, 0.f, 0.f, 0.f};
                if (act) {
                    const int b = row0 >> 11;
                    const float* sh = modl + (size_t)b * 12288 + 3 * 2048, *scl = sh + 2048;
                    f32x4 v[2][8]; float rstd[2];
#pragma unroll
                    for (int rr = 0; rr < 2; ++rr) { float ss = 0.f;
#pragma unroll
                        for (int j = 0; j < 8; ++j) { v[rr][j] = *(const f32x4*)(XA + (size_t)(row0 + rr) * D + 4 * lane + 256 * j); ss += (v[rr][j][0] * v[rr][j][0] + v[rr][j][1] * v[rr][j][1]) + (v[rr][j][2] * v[rr][j][2] + v[rr][j][3] * v[rr][j][3]); }
                        rstd[rr] = 1.0f / sqrtf(wave_sum(ss) * (1.0f / D) + EPS); }
#pragma unroll
                    for (int j = 0; j < 8; ++j) { const int col = 4 * lane + 256 * j;
                        const f32x4 gg = *(const f32x4*)(norm2_g + l * D + col), s1 = *(const f32x4*)(scl + col), h1 = *(const f32x4*)(sh + col);
#pragma unroll
                        for (int rr = 0; rr < 2; ++rr) { v[rr][j] = v[rr][j] * rstd[rr] * gg * (s1 + 1.0f) + h1;
                            u32x2 w; w.x = pk2(v[rr][j][0], v[rr][j][1]); w.y = pk2(v[rr][j][2], v[rr][j][3]); *(u32x2*)(Hb + (size_t)(row0 + rr) * D + col) = w; } }
                    float my0 = 0.f, my1 = 0.f;
#pragma unroll 2
                    for (int e = 0; e < 16; ++e) { float a0 = 0.f, a1 = 0.f;
#pragma unroll
                        for (int j = 0; j < 8; ++j) { const f32x4 w = *(const LAS f32x4*)(wT + e * 2048 + 4 * lane + 256 * j);
                            a0 += (v[0][j][0] * w[0] + v[0][j][1] * w[1]) + (v[0][j][2] * w[2] + v[0][j][3] * w[3]);
                            a1 += (v[1][j][0] * w[0] + v[1][j][1] * w[1]) + (v[1][j][2] * w[2] + v[1][j][3] * w[3]); }
                        const float t0 = wave_sum(a0), t1 = wave_sum(a1);
                        if (lane == e) { my0 = t0; my1 = t1; } }
                    float lg[2][16];
#pragma unroll
                    for (int e = 0; e < 16; ++e) { const float br = b_router[e];
                        lg[0][e] = __int_as_float(__builtin_amdgcn_readlane(__float_as_int(my0), e)) + br; lg[1][e] = __int_as_float(__builtin_amdgcn_readlane(__float_as_int(my1), e)) + br; }
#pragma unroll
                    for (int rr = 0; rr < 2; ++rr) {
                        float mx = lg[rr][0];
#pragma unroll
                        for (int e = 1; e < 16; ++e) mx = fmaxf(mx, lg[rr][e]);
                        float p[16];
#pragma unroll
                        for (int e = 0; e < 16; ++e) p[e] = fexp2((lg[rr][e] - mx) * LOG2E);
                        float bs = -1.f; int bg = 0; float bv0 = 0.f, bv1 = 0.f; int bi0 = 0, bi1 = 1;
#pragma unroll
                        for (int gq = 0; gq < 4; ++gq) {
                            float v0 = p[4 * gq]; int i0 = 0;
#pragma unroll
                            for (int k = 1; k < 4; ++k) if (p[4 * gq + k] > v0) { v0 = p[4 * gq + k]; i0 = k; }
                            float v1 = -1.f; int i1 = 0;
#pragma unroll
                            for (int k = 0; k < 4; ++k) if (k != i0 && p[4 * gq + k] > v1) { v1 = p[4 * gq + k]; i1 = k; }
                            const float sc = v0 + v1;
                            if (sc > bs) { bs = sc; bg = gq; bv0 = v0; bv1 = v1; bi0 = i0; bi1 = i1; } }
                        const float inv = 1.0f / (bv0 + bv1);
                        pe[2 * rr] = bg * 4 + bi0; pe[2 * rr + 1] = bg * 4 + bi1; pw[2 * rr] = bv0 * inv; pw[2 * rr + 1] = bv1 * inv; }
                    if (lane == 0) {
#pragma unroll
                        for (int k = 0; k < 4; ++k) prank[k] = __hip_atomic_fetch_add(&lcnt[pe[k]], 1, __ATOMIC_RELAXED, __HIP_MEMORY_SCOPE_WORKGROUP); }
                }
                __syncthreads();
                if (tid < 16) { const int cn = lcnt[tid]; int bs_ = 0; if (cn > 0) bs_ = (int)__hip_atomic_fetch_add(gcnt + tid * 64, (unsigned)cn, __ATOMIC_RELAXED, __HIP_MEMORY_SCOPE_AGENT); lbase[tid] = bs_; }
                __syncthreads();
                if (act && lane == 0) {
#pragma unroll
                    for (int k = 0; k < 4; ++k) { const int tok = row0 + (k >> 1); listl[pe[k] * 8192 + lbase[pe[k]] + prank[k]] = (unsigned)(tok * 2 + (k & 1)); twl[tok * 2 + (k & 1)] = pw[k]; } }
                __syncthreads();
                if (tid < 16) lcnt[tid] = 0;
                __syncthreads();
            }
        }
        SEAM(pb + 6);
        if ((PEN(9) || PEN(10)) && (IN(pb + 7) || IN(pb + 8))) {
            PHASE_IDS();
            unsigned char* ws = WSP(); const unsigned* listl = (const unsigned*)(ws + WS_LIST) + (size_t)l * 16 * 8192; gu32* gcnt = (gu32*)(ws + WS_CTL) + CW_CNT + l * 16 * 64;
            if (tid == 0) { int off = 0;
                for (int e = 0; e < 16; ++e) { const int cn = (int)__hip_atomic_load(gcnt + e * 64, __ATOMIC_RELAXED, __HIP_MEMORY_SCOPE_AGENT); moe[e] = cn; moe[16 + e] = off; off += (cn + 255) >> 8; }
                moe[32] = off; }
            __syncthreads();
            const int TT = moe[32];
            for (int s = 0; s < 4; ++s) { const int L = s * G + bid;
                if (L < TT * 8 && tid < 256) { const int mt = L >> 3; int e = 0;
#pragma unroll
                    for (int j = 1; j < 16; ++j) e += (mt >= moe[16 + j]) ? 1 : 0;
                    const int pos = (mt - moe[16 + e]) * 256 + tid;
                    rowtab[s * 256 + tid] = (pos < moe[e]) ? listl[e * 8192 + pos] : 0xFFFFFFFFu; } }
            __syncthreads();
        }
        if (PEN(9) && IN(pb + 7)) {
            PHASE_IDS();
            unsigned char* ws = WSP();
            pg8::Gemm g{(const bf16*)(ws + WS_H), WLP(ws, WL_GU), D, D, D}; pg8::MoeOrder S{moe, G, bid};
            pg8::EpiGU E{(bf16*)(ws + WS_ACT)};
            pg8::gemm_phase<pg8::EpiGU, pg8::MoeOrder, true>(tid, lds, g, S, E, rowtab);
        }
        SEAM(pb + 7);
        if (PEN(10) && IN(pb + 8)) {
            PHASE_IDS();
            unsigned char* ws = WSP();
            pg8::Gemm g{(const bf16*)(ws + WS_ACT), WLP(ws, WL_D), DFF, DFF, DFF}; pg8::MoeOrder S{moe, G, bid};
            pg8::EpiDown E{(bf16*)(ws + WS_YBUF), rowtab};
            pg8::gemm_phase<pg8::EpiDown, pg8::MoeOrder, false>(tid, lds, g, S, E, rowtab);
        }
        SEAM(pb + 8);
    }
    if (PEN(11) && IN(20)) {
        PHASE_IDS();
        unsigned char* ws = WSP(); const float* final_g = INP(18); float* outp = OUTP(); const float* MOD = (const float*)(ws + WS_MOD); const float* XA = (const float*)(ws + WS_XA); const bf16* YBUF = (const bf16*)(ws + WS_YBUF);
        const float* twp = (const float*)(ws + WS_TW) + (size_t)(DEPTH - 1) * T * 2;
        for (int row = gw; row < T; row += NGW) {
            const int b = row >> 11; const float w0 = twp[row * 2], w1 = twp[row * 2 + 1];
            const float* g2 = MOD + (size_t)((DEPTH - 1) * 4 + b) * 12288 + 5 * 2048;
            f32x4 v[8]; float ss = 0.f;
#pragma unroll
            for (int j = 0; j < 8; ++j) { const int col = 4 * lane + 256 * j;
                const f32x4 xv = *(const f32x4*)(XA + (size_t)row * D + col); const f32x4 gv = *(const f32x4*)(g2 + col);
                const u32x2 y0 = *(const u32x2*)(YBUF + (size_t)(row * 2) * D + col), y1 = *(const u32x2*)(YBUF + (size_t)(row * 2 + 1) * D + col);
                f32x4 mo; mo[0] = w0 * bf_lo(y0.x) + w1 * bf_lo(y1.x); mo[1] = w0 * bf_hi(y0.x) + w1 * bf_hi(y1.x); mo[2] = w0 * bf_lo(y0.y) + w1 * bf_lo(y1.y); mo[3] = w0 * bf_hi(y0.y) + w1 * bf_hi(y1.y);
                v[j] = xv + gv * mo; ss += (v[j][0] * v[j][0] + v[j][1] * v[j][1]) + (v[j][2] * v[j][2] + v[j][3] * v[j][3]); }
            const float rstd = 1.0f / sqrtf(wave_sum(ss) * (1.0f / D) + EPS);
#pragma unroll
            for (int j = 0; j < 8; ++j) { const int col = 4 * lane + 256 * j; const f32x4 gg = *(const f32x4*)(final_g + col);
                *(f32x4*)(outp + (size_t)row * D + col) = v[j] * rstd * gg; }
        }
    }
}

extern "C" void kernel_launch(void* const* d_in, const int* in_sizes, int n_in, void* d_out, int out_size, void* d_ws, size_t ws_size, hipStream_t stream) {
    static int grid = 0;
    if (grid == 0) {
        if (n_in != 19 || out_size != T * D || ws_size < WS_END) { fprintf(stderr, "kernel_launch: unexpected shapes (n_in %d out %d ws %zu)\n", n_in, out_size, ws_size); grid = -1; return; }
        int dev = 0, cus = 0, per_cu = 0;
        if (hipGetDevice(&dev) != hipSuccess || hipDeviceGetAttribute(&cus, hipDeviceAttributeMultiprocessorCount, dev) != hipSuccess) { grid = -1; return; }
        if (hipFuncSetAttribute((const void*)fwd_kernel, hipFuncAttributeMaxDynamicSharedMemorySize, LDS_BYTES) != hipSuccess) { fprintf(stderr, "kernel_launch: hipFuncSetAttribute failed\n"); grid = -1; return; }
        if (hipOccupancyMaxActiveBlocksPerMultiprocessor(&per_cu, (const void*)fwd_kernel, 512, LDS_BYTES) != hipSuccess || per_cu < 1) { fprintf(stderr, "kernel_launch: occupancy query says %d\n", per_cu); }
        (void)hipGetLastError();
        grid = cus;
    }
    if (grid < 0) return;
    (void)hipMemsetAsync((char*)d_ws + WS_CTL, 0, CTL_ZERO_BYTES, stream);
    Args a{};
    for (int i = 0; i < 19; ++i) a.in[i] = d_in[i];
    a.out = (float*)d_out; a.ws = (unsigned char*)d_ws;
#if MK_ONE_LAUNCH
    a.ph_lo = 0; a.ph_hi = 21;
    hipLaunchKernelGGL(fwd_kernel, dim3(grid), dim3(512), LDS_BYTES, stream, a);
#else
    for (int p = 0; p < 21; ++p) { a.ph_lo = p; a.ph_hi = p + 1; hipLaunchKernelGGL(fwd_kernel, dim3(grid), dim3(512), LDS_BYTES, stream, a); }
#endif
}
```
